# Optimizing an MI355X kernel written in HIP

```python
import math
import jax, jax.numpy as jnp
from jax import lax
import numpy as np

D_MODEL = 1024
BATCH = 8
SEQ = 2048
DEPTH = 1

HEAD_DIM = 64
ATTN_WIDTH = D_MODEL // 2
ATTN_HEADS = ATTN_WIDTH // HEAD_DIM
MOBA_BLOCK = 256
MOBA_TOPK = 3
Q_CHUNK = 32
POOL_WINDOWS = (2, 4, 8, 16)
POOL_GROUPS = len(POOL_WINDOWS)
POOL_WIDTH = D_MODEL // 2
POOL_GROUP_WIDTH = POOL_WIDTH // POOL_GROUPS
N_BRANCHES = 2
IN_WIDTH = 3 * ATTN_WIDTH + POOL_WIDTH + N_BRANCHES * D_MODEL
D_FF = 2816
RPB_BUCKETS = 32
RPB_MAX_DISTANCE = 128
RMS_EPS = 1e-6

kernel_name = "hybrid_moba_pool_macaron_block"


def rms_norm(x, g):
    x32 = x.astype(jnp.float32)
    y = x32 * lax.rsqrt(jnp.mean(x32 * x32, axis=-1, keepdims=True) + RMS_EPS)
    return (y * g.astype(jnp.float32)).astype(x.dtype)


def swiglu(x, w_gate, w_up, w_down):
    return (jax.nn.silu(x @ w_gate) * (x @ w_up)) @ w_down


def rpb_bucket(dist):
    n = jnp.maximum(dist, 0)
    max_exact = RPB_BUCKETS // 2
    nf = jnp.maximum(n, 1).astype(jnp.float32)
    large = max_exact + (jnp.log(nf / max_exact) / math.log(RPB_MAX_DISTANCE / max_exact)
                         * (RPB_BUCKETS - max_exact)).astype(jnp.int32)
    large = jnp.minimum(large, RPB_BUCKETS - 1)
    return jnp.where(n < max_exact, n, large)


def moba_attention(q, k, v, rpb_table):
    B, H, S, Dh = q.shape
    nb = -(-S // MOBA_BLOCK)
    s_pad = nb * MOBA_BLOCK
    pad = ((0, 0), (0, 0), (0, s_pad - S), (0, 0))
    k_pad = jnp.pad(k, pad)
    v_pad = jnp.pad(v, pad)
    k_blocks = k_pad.reshape(B, H, nb, MOBA_BLOCK, Dh)
    v_blocks = v_pad.reshape(B, H, nb, MOBA_BLOCK, Dh)
    k_mean = jnp.mean(k_blocks, axis=3)
    pos = jnp.arange(S, dtype=jnp.int32)
    q_blk = pos // MOBA_BLOCK
    gate = jnp.einsum('bhsd,bhnd->bhsn', q, k_mean).astype(jnp.float32)
    past = jnp.arange(nb, dtype=jnp.int32)[None, :] < q_blk[:, None]
    gate = jnp.where(past, gate, -jnp.inf)
    n_sel = min(MOBA_TOPK, nb)
    _, sel_idx = lax.top_k(gate, n_sel)
    table_hb = rpb_table.astype(jnp.float32).T
    scale = HEAD_DIM ** -0.5
    bi = jnp.arange(B)[:, None, None, None]
    hi = jnp.arange(H)[None, :, None, None]
    offs = jnp.arange(MOBA_BLOCK, dtype=jnp.int32)

    def chunk(c):
        t0 = c * Q_CHUNK
        ib = t0 // MOBA_BLOCK
        tq = t0 + jnp.arange(Q_CHUNK, dtype=jnp.int32)
        qc = lax.dynamic_slice_in_dim(q, t0, Q_CHUNK, axis=2)
        idx = lax.dynamic_slice_in_dim(sel_idx, t0, Q_CHUNK, axis=2)
        kg = k_blocks[bi, hi, idx]
        vg = v_blocks[bi, hi, idx]
        kpos_sel = idx[..., None] * MOBA_BLOCK + offs
        lg_sel = jnp.einsum('bhqd,bhqnkd->bhqnk', qc, kg).astype(jnp.float32) * scale
        lg_sel = lg_sel + table_hb[hi[..., None], rpb_bucket(tq[:, None, None] - kpos_sel)]
        valid = jnp.arange(n_sel, dtype=jnp.int32) < ib
        lg_sel = jnp.where(valid[:, None], lg_sel, -jnp.inf)
        ko = lax.dynamic_slice_in_dim(k_pad, ib * MOBA_BLOCK, MOBA_BLOCK, axis=2)
        vo = lax.dynamic_slice_in_dim(v_pad, ib * MOBA_BLOCK, MOBA_BLOCK, axis=2)
        dist = tq[:, None] - (ib * MOBA_BLOCK + offs)[None, :]
        lg_own = jnp.einsum('bhqd,bhkd->bhqk', qc, ko).astype(jnp.float32) * scale
        lg_own = lg_own + table_hb[:, rpb_bucket(dist)]
        lg_own = jnp.where(dist >= 0, lg_own, -jnp.inf)
        logits = jnp.concatenate([lg_sel.reshape(B, H, Q_CHUNK, n_sel * MOBA_BLOCK), lg_own], axis=-1)
        p = jax.nn.softmax(logits, axis=-1).astype(v.dtype)
        p_sel = p[..., :n_sel * MOBA_BLOCK].reshape(B, H, Q_CHUNK, n_sel, MOBA_BLOCK)
        p_own = p[..., n_sel * MOBA_BLOCK:]
        return (jnp.einsum('bhqnk,bhqnkd->bhqd', p_sel, vg)
                + jnp.einsum('bhqk,bhkd->bhqd', p_own, vo))

    outs = lax.map(chunk, jnp.arange(S // Q_CHUNK, dtype=jnp.int32))
    return outs.transpose(1, 2, 0, 3, 4).reshape(B, H, S, Dh)


def pool_mixer(z, w_group, ch_scale):
    B, S, _ = z.shape
    G = POOL_GROUP_WIDTH
    z32 = z.astype(jnp.float32)
    c_pad = jnp.concatenate([jnp.zeros((B, 1, POOL_WIDTH), jnp.float32),
                             jnp.cumsum(z32, axis=1)], axis=1)
    t1 = jnp.arange(1, S + 1, dtype=jnp.float32)
    outs = []
    for g, w in enumerate(POOL_WINDOWS):
        sl = slice(g * G, (g + 1) * G)
        cg = c_pad[:, :, sl]
        lag = jnp.concatenate([jnp.zeros((B, w - 1, G), jnp.float32), cg[:, :S - w + 1]], axis=1)
        mean = (cg[:, 1:] - lag) / jnp.minimum(t1, float(w))[None, :, None]
        outs.append(mean - z32[:, :, sl])
    pooled = jnp.stack(outs, axis=2).astype(z.dtype)
    mixed = jnp.einsum('bsgc,gcd->bsgd', pooled, w_group).reshape(B, S, POOL_WIDTH)
    return mixed * ch_scale


def setup_inputs(seed: int = 0) -> dict:
    key = jax.random.key(seed)
    ks = jax.random.split(key, 20)
    f32 = jnp.float32
    L = DEPTH

    def w(k, shape, fan_in):
        return jax.random.normal(k, shape, f32) * (fan_in ** -0.5)

    def gain(k, shape):
        return 1.0 + 0.02 * jax.random.normal(k, shape, f32)

    return {
        "x": jax.random.normal(ks[0], (BATCH, SEQ, D_MODEL), f32),
        "ffn1_norm": gain(ks[1], (L, D_MODEL)),
        "ffn1_w_gate": w(ks[2], (L, D_MODEL, D_FF), D_MODEL),
        "ffn1_w_up": w(ks[3], (L, D_MODEL, D_FF), D_MODEL),
        "ffn1_w_down": w(ks[4], (L, D_FF, D_MODEL), D_FF),
        "mix_norm": gain(ks[5], (L, D_MODEL)),
        "w_in": w(ks[6], (L, D_MODEL, IN_WIDTH), D_MODEL),
        "pool_w_group": w(ks[7], (L, POOL_GROUPS, POOL_GROUP_WIDTH, POOL_GROUP_WIDTH), POOL_GROUP_WIDTH),
        "pool_scale": gain(ks[8], (L, POOL_WIDTH)) + 0.08 * jax.random.normal(ks[9], (L, POOL_WIDTH), f32),
        "w_branch_attn": w(ks[10], (L, ATTN_WIDTH, D_MODEL), ATTN_WIDTH),
        "w_branch_pool": w(ks[11], (L, POOL_WIDTH, D_MODEL), POOL_WIDTH),
        "w_out": w(ks[12], (L, D_MODEL, D_MODEL), D_MODEL),
        "ffn2_norm": gain(ks[13], (L, D_MODEL)),
        "ffn2_w_gate": w(ks[14], (L, D_MODEL, D_FF), D_MODEL),
        "ffn2_w_up": w(ks[15], (L, D_MODEL, D_FF), D_MODEL),
        "ffn2_w_down": w(ks[16], (L, D_FF, D_MODEL), D_FF),
        "rpb_table": 0.5 * jax.random.normal(ks[17], (RPB_BUCKETS, ATTN_HEADS), f32),
        "final_norm": gain(ks[18], (D_MODEL,)),
    }


def reference(x, ffn1_norm, ffn1_w_gate, ffn1_w_up, ffn1_w_down, mix_norm, w_in,
              pool_w_group, pool_scale, w_branch_attn, w_branch_pool, w_out,
              ffn2_norm, ffn2_w_gate, ffn2_w_up, ffn2_w_down, rpb_table, final_norm):
    B, S, _ = x.shape
    h = x
    for l in range(DEPTH):
        h = h + 0.5 * swiglu(rms_norm(h, ffn1_norm[l]), ffn1_w_gate[l], ffn1_w_up[l], ffn1_w_down[l])
        u = rms_norm(h, mix_norm[l])
        proj = u @ w_in[l]
        q, k, v, z, g_attn, g_pool = jnp.split(
            proj, np.cumsum([ATTN_WIDTH, ATTN_WIDTH, ATTN_WIDTH, POOL_WIDTH, D_MODEL]).tolist(), axis=-1)
        to_heads = lambda t: t.reshape(B, S, ATTN_HEADS, HEAD_DIM).transpose(0, 2, 1, 3)
        a = moba_attention(to_heads(q), to_heads(k), to_heads(v), rpb_table)
        a = a.transpose(0, 2, 1, 3).reshape(B, S, ATTN_WIDTH)
        p = pool_mixer(z, pool_w_group[l], pool_scale[l])
        merged = (jax.nn.sigmoid(g_attn) * (a @ w_branch_attn[l])
                  + jax.nn.sigmoid(g_pool) * (p @ w_branch_pool[l]))
        h = h + merged @ w_out[l]
        h = h + 0.5 * swiglu(rms_norm(h, ffn2_norm[l]), ffn2_w_gate[l], ffn2_w_up[l], ffn2_w_down[l])
    return rms_norm(h, final_norm)
```

```cpp
#include <hip/hip_runtime.h>
#include <cstdio>
#include <cstdint>
#include <cmath>
namespace pg8 {
#define PG8_LAS __attribute__((address_space(3)))
typedef unsigned short bf16_t;
typedef short bf16x8 __attribute__((ext_vector_type(8)));
typedef float f32x4 __attribute__((ext_vector_type(4)));
typedef unsigned u32x4 __attribute__((ext_vector_type(4)));
constexpr int BM = 256, BK = 64, HALF = 128, HTB = HALF * BK * 2  , STAGE_BYTES = 8 * HTB, NXCD = 8, WGM = 8;

__host__ __device__ __forceinline__ int lds_byte(int r, int c) { const int st = (r >> 4) * 2 + (c >> 5), rr = r & 15, cc = c & 31, ob = rr * 64 + cc * 2; return st * 1024 + (ob ^ (((ob >> 9) & 1) << 5)); }
__host__ __device__ __forceinline__ void stage_rc(int b, int& R, int& C) { const int st = b / 1024, sb = b % 1024, swz = sb ^ (((sb >> 9) & 1) << 5); R = (st >> 1) * 16 + swz / 64; C = (st & 1) * 32 + (swz % 64) / 2; }
__host__ __device__ __forceinline__ int perm32(int rho) { const int n = rho >> 4, i = rho & 15; return 8 * (i >> 2) + 4 * n + (i & 3); }

struct Unit { int pm, pn; };
struct Gemm { const bf16_t* A; const bf16_t* Bt; int M, N, K; };

struct StaticOrder {
    int nM, nN, nwg, G, c;
    __host__ __device__ void init(int M, int N, int G_, int c_) { nM = M / BM; nN = N / BM; nwg = nM * nN; G = G_; c = c_; }
    __host__ __device__ bool next(int i, Unit& u) const {
        const long L = (long)i * G + c; if (L >= nwg) return false;
        int wgid = (int)L; { const int q = nwg / NXCD, r = nwg % NXCD, xcd = wgid % NXCD, off = wgid / NXCD; wgid = (xcd < r ? xcd * (q + 1) : r * (q + 1) + (xcd - r) * q) + off; }
        const int nig = WGM * nN, gid = wgid / nig, fm = gid * WGM, gsz = (nM - fm) < WGM ? (nM - fm) : WGM;
        u.pm = fm + ((wgid % nig) % gsz); u.pn = (wgid % nig) / gsz; return true;
    }
    __device__ __forceinline__ void a_ready(const Unit&) const {}
    __device__ __forceinline__ void done(const Unit&) const {}
};

typedef unsigned u32x2 __attribute__((ext_vector_type(2)));
typedef float f32x2_t __attribute__((ext_vector_type(2)));
typedef __bf16 bf16x2_t __attribute__((ext_vector_type(2)));
__device__ __forceinline__ unsigned cvt_pk_bf16(float lo, float hi) { f32x2_t v = {lo, hi}; bf16x2_t b = __builtin_convertvector(v, bf16x2_t); return __builtin_bit_cast(unsigned, b); }
__device__ __forceinline__ float bf_lo(unsigned w) { return __builtin_bit_cast(float, w << 16); }
__device__ __forceinline__ float bf_hi(unsigned w) { return __builtin_bit_cast(float, w & 0xffff0000u); }
__device__ __forceinline__ float clampf(float v, float lo, float hi) { return __builtin_fminf(__builtin_fmaxf(v, lo), hi); }
constexpr float LOG2E = 1.4426950408889634f;
__device__ __forceinline__ float sigmoid_den(float g) { return 1.0f + __builtin_amdgcn_exp2f(-LOG2E * clampf(g, -60.f, 60.f)); }
__device__ __forceinline__ float silu_mul(float g, float u) { return g * u * __builtin_amdgcn_rcpf(sigmoid_den(g)); }

struct EpiSwiGLU {
    static constexpr bool PERM = true, AFTER_DRAIN = false, MID = false;
    bf16_t* O; int ldc;
    __device__ __forceinline__ void operator()(const f32x4 (&acc)[2][2][4][2], const Unit& u, int wr, int wc, int fr, int fq) const {
        const int row0 = u.pm * BM + wr * 64 + fr, col0 = u.pn * HALF + wc * 32 + 8 * fq;
#pragma unroll
        for (int ai = 0; ai < 2; ++ai)
#pragma unroll
            for (int m = 0; m < 4; ++m) { bf16_t* rowp = O + (size_t)(row0 + ai * HALF + m * 16) * ldc + col0;
                const f32x4 g0 = acc[ai][0][m][0], g1 = acc[ai][0][m][1], u0 = acc[ai][1][m][0], u1 = acc[ai][1][m][1];
                u32x4 w; w.x = cvt_pk_bf16(silu_mul(g0[0], u0[0]), silu_mul(g0[1], u0[1])); w.y = cvt_pk_bf16(silu_mul(g0[2], u0[2]), silu_mul(g0[3], u0[3]));
                w.z = cvt_pk_bf16(silu_mul(g1[0], u1[0]), silu_mul(g1[1], u1[1])); w.w = cvt_pk_bf16(silu_mul(g1[2], u1[2]), silu_mul(g1[3], u1[3]));
                *(u32x4*)rowp = w; }
    }
};
struct EpiResF32 {
    static constexpr bool PERM = false, AFTER_DRAIN = false, MID = false;
    const float* base; float* out; int ldc; float s;
    __device__ __forceinline__ void operator()(const f32x4 (&acc)[2][2][4][2], const Unit& u, int wr, int wc, int fr, int fq) const {
        const int row0 = u.pm * BM + wr * 64 + fr, col0 = u.pn * BM + wc * 32 + 4 * fq;
#pragma unroll
        for (int ai = 0; ai < 2; ++ai)
#pragma unroll
            for (int m = 0; m < 4; ++m) { const size_t off = (size_t)(row0 + ai * HALF + m * 16) * ldc + col0;
                f32x4 b[2][2];
#pragma unroll
                for (int bj = 0; bj < 2; ++bj)
#pragma unroll
                    for (int n = 0; n < 2; ++n) b[bj][n] = *(const f32x4*)(base + off + bj * HALF + n * 16);
#pragma unroll
                for (int bj = 0; bj < 2; ++bj)
#pragma unroll
                    for (int n = 0; n < 2; ++n) *(f32x4*)(out + off + bj * HALF + n * 16) = b[bj][n] + acc[ai][bj][m][n] * s; }
    }
};
struct EpiWin {
    static constexpr bool PERM = true, AFTER_DRAIN = false, MID = false;
    bf16_t* QKVZ; size_t split_stride; float qscale; bf16_t* R; bf16_t* SGP;
    __device__ __forceinline__ void operator()(const f32x4 (&acc)[2][2][4][2], const Unit& u, int wr, int wc, int fr, int fq) const {
        const int row0 = u.pm * BM + wr * 64 + fr;
        if (u.pn < 8) {
            const int t = u.pn >> 1; bf16_t* base = QKVZ + (size_t)t * split_stride; const float sc = (t == 0) ? qscale : 1.f;
            const int col0 = (u.pn & 1) * BM + wc * 32 + 8 * fq;
#pragma unroll
            for (int ai = 0; ai < 2; ++ai)
#pragma unroll
                for (int m = 0; m < 4; ++m) { bf16_t* rowp = base + (size_t)(row0 + ai * HALF + m * 16) * 512 + col0;
#pragma unroll
                    for (int bj = 0; bj < 2; ++bj) { const f32x4 v0 = acc[ai][bj][m][0] * sc, v1 = acc[ai][bj][m][1] * sc;
                        u32x4 w; w.x = cvt_pk_bf16(v0[0], v0[1]); w.y = cvt_pk_bf16(v0[2], v0[3]); w.z = cvt_pk_bf16(v1[0], v1[1]); w.w = cvt_pk_bf16(v1[2], v1[3]);
                        *(u32x4*)(rowp + bj * HALF) = w; } }
        } else {
            const int col0 = (u.pn - 8) * HALF + wc * 32 + 8 * fq;
#pragma unroll
            for (int ai = 0; ai < 2; ++ai)
#pragma unroll
                for (int m = 0; m < 4; ++m) { const size_t off = (size_t)(row0 + ai * HALF + m * 16) * 1024 + col0;
                    float r[8], s[8];
#pragma unroll
                    for (int n = 0; n < 2; ++n)
#pragma unroll
                        for (int j = 0; j < 4; ++j) { const float da = sigmoid_den(acc[ai][0][m][n][j]), dp = sigmoid_den(acc[ai][1][m][n][j]);
                            s[n * 4 + j] = __builtin_amdgcn_rcpf(dp); r[n * 4 + j] = dp * __builtin_amdgcn_rcpf(da); }
                    u32x4 wr_, ws_; wr_.x = cvt_pk_bf16(r[0], r[1]); wr_.y = cvt_pk_bf16(r[2], r[3]); wr_.z = cvt_pk_bf16(r[4], r[5]); wr_.w = cvt_pk_bf16(r[6], r[7]);
                    ws_.x = cvt_pk_bf16(s[0], s[1]); ws_.y = cvt_pk_bf16(s[2], s[3]); ws_.z = cvt_pk_bf16(s[4], s[5]); ws_.w = cvt_pk_bf16(s[6], s[7]);
                    *(u32x4*)(R + off) = wr_; *(u32x4*)(SGP + off) = ws_; }
        }
    }
};
struct EpiMerged {
    static constexpr bool PERM = true, AFTER_DRAIN = false, MID = true;
    const bf16_t* R; const bf16_t* SGP; bf16_t* O;
    __device__ __forceinline__ void mid(f32x4 (&acc)[2][2][4][2], const Unit& u, int wr, int wc, int fr, int fq) const {
        int row0 = u.pm * BM + wr * 64 + fr, col0 = u.pn * BM + wc * 32 + 8 * fq;
        asm volatile("" : "+v"(row0), "+v"(col0));
#pragma unroll
        for (int ai = 0; ai < 2; ++ai)
#pragma unroll
            for (int m = 0; m < 4; ++m) { const size_t off = (size_t)(row0 + ai * HALF + m * 16) * 1024 + col0;
#pragma unroll
                for (int bj = 0; bj < 2; ++bj) { const u32x4 w = *(const u32x4*)(R + off + bj * HALF);
                    acc[ai][bj][m][0] *= (f32x4){bf_lo(w.x), bf_hi(w.x), bf_lo(w.y), bf_hi(w.y)}; acc[ai][bj][m][1] *= (f32x4){bf_lo(w.z), bf_hi(w.z), bf_lo(w.w), bf_hi(w.w)}; } }
    }
    __device__ __forceinline__ void operator()(const f32x4 (&acc)[2][2][4][2], const Unit& u, int wr, int wc, int fr, int fq) const {
        const int row0 = u.pm * BM + wr * 64 + fr, col0 = u.pn * BM + wc * 32 + 8 * fq;
#pragma unroll
        for (int ai = 0; ai < 2; ++ai)
#pragma unroll
            for (int m = 0; m < 4; ++m) { const size_t off = (size_t)(row0 + ai * HALF + m * 16) * 1024 + col0;
#pragma unroll
                for (int bj = 0; bj < 2; ++bj) { const u32x4 w = *(const u32x4*)(SGP + off + bj * HALF);
                    const f32x4 v0 = acc[ai][bj][m][0] * (f32x4){bf_lo(w.x), bf_hi(w.x), bf_lo(w.y), bf_hi(w.y)}, v1 = acc[ai][bj][m][1] * (f32x4){bf_lo(w.z), bf_hi(w.z), bf_lo(w.w), bf_hi(w.w)};
                    u32x4 o; o.x = cvt_pk_bf16(v0[0], v0[1]); o.y = cvt_pk_bf16(v0[2], v0[3]); o.z = cvt_pk_bf16(v1[0], v1[1]); o.w = cvt_pk_bf16(v1[2], v1[3]);
                    *(u32x4*)(O + off + bj * HALF) = o; } }
    }
};

template <class Epi, class Sched, bool ALIGN_EPI = false, bool SP2 = false>
__device__ __forceinline__ void gemm_phase(PG8_LAS unsigned char* lds, const Gemm g, const Sched& S, const Epi& E) {
    int tid = threadIdx.x; asm volatile("" : "+v"(tid));
    const int wid = __builtin_amdgcn_readfirstlane(tid >> 6), lane = tid & 63, wr = wid >> 2, wc = wid & 3, fr = lane & 15, fq = lane >> 4;
    const int K = g.K, nt = K / BK;
    unsigned voffA[2], voffB[2];
#pragma unroll
    for (int i = 0; i < 2; ++i) { int R, C; stage_rc(tid * 16 + i * 8192, R, C); const int Rb = Epi::PERM ? ((R & ~31) + perm32(R & 31)) : R;
        voffA[i] = (unsigned)(R * K + C) * 2u; voffB[i] = (unsigned)(Rb * K + C) * 2u; }
    const size_t kstep = (size_t)(BK * 2);
    const size_t hstep = (size_t)HALF * K * 2;
    const size_t tstep = 2 * hstep;
    const unsigned ldsw = (unsigned)wid * 1024u;
    const int aoff = lds_byte(wr * 64 + fr, fq * 8), boff = lds_byte(wc * 32 + fr, fq * 8);
#define PG8_SA(b, h) (((b) * 2 + (h)) * HTB)
#define PG8_SB(b, h) ((4 + (b) * 2 + (h)) * HTB)
#define PG8_STAGE(bufoff, gbase, voff) do { _Pragma("unroll") for (int _i = 0; _i < 2; ++_i) \
        __builtin_amdgcn_global_load_lds((const unsigned*)((const char*)(gbase) + (voff)[_i]), (PG8_LAS unsigned*)(lds + (bufoff) + ldsw + _i * 8192), 16, 0, 0); } while (0)
#define PG8_LDA(dst, b, h) do { _Pragma("unroll") for (int m = 0; m < 4; ++m) _Pragma("unroll") for (int k = 0; k < 2; ++k) dst[m][k] = *(const PG8_LAS bf16x8*)(lds + PG8_SA(b, h) + aoff + m * 2048 + k * 1024); } while (0)
#define PG8_LDB(dst, b, h) do { _Pragma("unroll") for (int n = 0; n < 2; ++n) _Pragma("unroll") for (int k = 0; k < 2; ++k) dst[n][k] = *(const PG8_LAS bf16x8*)(lds + PG8_SB(b, h) + boff + n * 2048 + k * 1024); } while (0)
#define PG8_MMA(ai, bj, At, Bt) do { __builtin_amdgcn_s_setprio(1); _Pragma("unroll") for (int m = 0; m < 4; ++m) _Pragma("unroll") for (int n = 0; n < 2; ++n) _Pragma("unroll") for (int k = 0; k < 2; ++k) \
        acc[ai][bj][m][n] = __builtin_amdgcn_mfma_f32_16x16x32_bf16(Bt[n][k], At[m][k], acc[ai][bj][m][n], 0, 0, 0); __builtin_amdgcn_s_setprio(0); } while (0)
#define PG8_WAIT_V(n) asm volatile("s_waitcnt vmcnt(" #n ")" ::: "memory")
#define PG8_WAIT_L(n) asm volatile("s_waitcnt lgkmcnt(" #n ")" ::: "memory")
#define PG8_BAR __builtin_amdgcn_s_barrier()
#define PG8_SCHED __builtin_amdgcn_sched_barrier(0)
    Unit cur, nxt; int ui = 0;
    if (!S.next(0, cur)) return;
    f32x4 acc[2][2][4][2];
#pragma unroll
    for (int a = 0; a < 2; ++a)
#pragma unroll
        for (int b = 0; b < 2; ++b)
#pragma unroll
            for (int m = 0; m < 4; ++m)
#pragma unroll
                for (int n = 0; n < 2; ++n) acc[a][b][m][n] = (f32x4){0.f, 0.f, 0.f, 0.f};
    bf16x8 At[4][2], B0[2][2], B1[2][2];
    const char* cA = (const char*)g.A + (size_t)cur.pm * tstep; const char* cB = (const char*)g.Bt + (size_t)cur.pn * tstep;
    S.a_ready(cur);
    if constexpr (SP2) {
        PG8_STAGE(PG8_SB(0, 0), cB, voffB); PG8_STAGE(PG8_SB(0, 1), cB + hstep, voffB); PG8_STAGE(PG8_SA(0, 0), cA, voffA); PG8_STAGE(PG8_SA(0, 1), cA + hstep, voffA);
        if (wr == 1) PG8_BAR;
        PG8_WAIT_V(2); PG8_BAR;
        PG8_STAGE(PG8_SB(1, 0), cB + kstep, voffB); PG8_STAGE(PG8_SA(1, 0), cA + kstep, voffA); PG8_STAGE(PG8_SB(1, 1), cB + hstep + kstep, voffB);
        PG8_WAIT_V(6); PG8_BAR;
    } else {
        PG8_STAGE(PG8_SB(0, 0), cB, voffB); PG8_STAGE(PG8_SA(0, 0), cA, voffA); PG8_STAGE(PG8_SB(0, 1), cB + hstep, voffB); PG8_STAGE(PG8_SA(0, 1), cA + hstep, voffA);
        if (wr == 1) PG8_BAR;
        PG8_WAIT_V(4); PG8_BAR;
        PG8_STAGE(PG8_SB(1, 0), cB + kstep, voffB); PG8_STAGE(PG8_SA(1, 0), cA + kstep, voffA); PG8_STAGE(PG8_SB(1, 1), cB + hstep + kstep, voffB);
        PG8_WAIT_V(6); PG8_BAR;
    }
    for (;;) {
        const bool has_next = S.next(ui + 1, nxt);
        const char* nA = has_next ? (const char*)g.A + (size_t)nxt.pm * tstep : cA; const char* nB = has_next ? (const char*)g.Bt + (size_t)nxt.pn * tstep : cB;
        for (int t = 0; t < nt; t += 2) {
            if constexpr (Epi::MID) { if (t == (nt >> 1)) E.mid(acc, cur, wr, wc, fr, fq); }
            const bool last = (t == nt - 2);
            const char* a1 = cA + (size_t)(t + 1) * kstep;
            const char* a2 = last ? nA : cA + (size_t)(t + 2) * kstep; const char* b2 = last ? nB : cB + (size_t)(t + 2) * kstep;
            const char* a3 = a2 + kstep; const char* b3 = b2 + kstep;
            if (last && has_next) S.a_ready(nxt);
            if constexpr (SP2) {
            PG8_LDB(B0, 0, 0); PG8_LDB(B1, 0, 1); PG8_SCHED; PG8_LDA(At, 0, 0); PG8_STAGE(PG8_SA(1, 1), a1 + hstep, voffA);
            PG8_WAIT_V(8); PG8_WAIT_L(0); PG8_BAR; PG8_MMA(0, 0, At, B0); PG8_MMA(0, 1, At, B1); PG8_BAR; PG8_SCHED;
            PG8_LDA(At, 0, 1); PG8_STAGE(PG8_SB(0, 0), b2, voffB); PG8_STAGE(PG8_SB(0, 1), b2 + hstep, voffB); PG8_STAGE(PG8_SA(0, 0), a2, voffA);
            PG8_WAIT_V(8); PG8_WAIT_L(0); PG8_BAR; PG8_MMA(1, 0, At, B0); PG8_MMA(1, 1, At, B1); PG8_BAR; PG8_SCHED;
            PG8_LDB(B0, 1, 0); PG8_LDB(B1, 1, 1); PG8_SCHED; PG8_LDA(At, 1, 0); PG8_STAGE(PG8_SA(0, 1), a2 + hstep, voffA);
            PG8_WAIT_V(8); PG8_WAIT_L(0); PG8_BAR; PG8_MMA(0, 0, At, B0); PG8_MMA(0, 1, At, B1); PG8_BAR; PG8_SCHED;
            PG8_LDA(At, 1, 1); PG8_STAGE(PG8_SB(1, 0), b3, voffB); PG8_STAGE(PG8_SB(1, 1), b3 + hstep, voffB); PG8_STAGE(PG8_SA(1, 0), a3, voffA);
            PG8_WAIT_V(8); PG8_WAIT_L(0); PG8_BAR; PG8_MMA(1, 0, At, B0); PG8_MMA(1, 1, At, B1); PG8_BAR; PG8_SCHED;
            } else {
            PG8_LDB(B0, 0, 0); PG8_SCHED; PG8_LDA(At, 0, 0); PG8_STAGE(PG8_SA(1, 1), a1 + hstep, voffA);
            PG8_WAIT_L(8); PG8_BAR; PG8_WAIT_L(0); PG8_MMA(0, 0, At, B0); PG8_BAR; PG8_SCHED;
            PG8_LDB(B1, 0, 1); PG8_STAGE(PG8_SB(0, 0), b2, voffB);
            PG8_BAR; PG8_WAIT_L(0); PG8_MMA(0, 1, At, B1); PG8_BAR;
            PG8_LDA(At, 0, 1); PG8_STAGE(PG8_SA(0, 0), a2, voffA);
            PG8_BAR; PG8_WAIT_L(0); PG8_MMA(1, 0, At, B0); PG8_BAR; PG8_SCHED;
            PG8_STAGE(PG8_SB(0, 1), b2 + hstep, voffB);
            PG8_WAIT_V(6); PG8_BAR; PG8_MMA(1, 1, At, B1); PG8_BAR;
            PG8_LDB(B0, 1, 0); PG8_SCHED; PG8_LDA(At, 1, 0); PG8_STAGE(PG8_SA(0, 1), a2 + hstep, voffA);
            PG8_WAIT_L(8); PG8_BAR; PG8_WAIT_L(0); PG8_MMA(0, 0, At, B0); PG8_BAR; PG8_SCHED;
            PG8_LDB(B1, 1, 1); PG8_STAGE(PG8_SB(1, 0), b3, voffB);
            PG8_BAR; PG8_WAIT_L(0); PG8_MMA(0, 1, At, B1); PG8_BAR;
            PG8_LDA(At, 1, 1); PG8_STAGE(PG8_SA(1, 0), a3, voffA);
            PG8_BAR; PG8_WAIT_L(0); PG8_MMA(1, 0, At, B0); PG8_BAR; PG8_SCHED;
            PG8_STAGE(PG8_SB(1, 1), b3 + hstep, voffB);
            PG8_WAIT_V(6); PG8_BAR; PG8_MMA(1, 1, At, B1); PG8_BAR;
            }
        }
        if constexpr (ALIGN_EPI) { if (wr == 0) PG8_BAR; }
        if constexpr (!Epi::AFTER_DRAIN) { E(acc, cur, wr, wc, fr, fq); S.done(cur); }
        if (!has_next) break;
#pragma unroll
        for (int a = 0; a < 2; ++a)
#pragma unroll
            for (int b = 0; b < 2; ++b)
#pragma unroll
                for (int m = 0; m < 4; ++m)
#pragma unroll
                    for (int n = 0; n < 2; ++n) acc[a][b][m][n] = (f32x4){0.f, 0.f, 0.f, 0.f};
        cur = nxt; cA = nA; cB = nB; ++ui;
        if constexpr (ALIGN_EPI) { if (wr == 1) PG8_BAR; }
    }
    PG8_WAIT_V(0);
    if constexpr (!ALIGN_EPI) { if (wr == 0) PG8_BAR; }
    PG8_BAR;
    if constexpr (Epi::AFTER_DRAIN) { E.fused(acc, cur, wr, wc, fr, fq, lds, wid, lane); S.done(cur); }
#undef PG8_SA
#undef PG8_SB
#undef PG8_STAGE
#undef PG8_LDA
#undef PG8_LDB
#undef PG8_MMA
#undef PG8_WAIT_V
#undef PG8_WAIT_L
#undef PG8_BAR
#undef PG8_SCHED
}
}

constexpr int BATCH = 8, SEQ = 2048, DM = 1024, M_TOK = BATCH * SEQ, DFF = 2816, NH = 8, HD = 64, AW = 512, PW = 512, INW = 4096, MBLK = 256, NBLK = SEQ / MBLK;
constexpr float RMS_EPS = 1e-6f;
constexpr int NWAVES = 8;

#define GAS __attribute__((address_space(1)))
#define LAS __attribute__((address_space(3)))
typedef unsigned short bf16;
typedef unsigned v4u __attribute__((ext_vector_type(4)));
typedef unsigned v2u __attribute__((ext_vector_type(2)));
typedef float f32x4 __attribute__((ext_vector_type(4)));
typedef float f32x16 __attribute__((ext_vector_type(16)));
typedef short bf16x8 __attribute__((ext_vector_type(8)));
typedef short s16x4 __attribute__((ext_vector_type(4)));
typedef GAS unsigned gu32;
#define RLX_AGENT __ATOMIC_RELAXED, __HIP_MEMORY_SCOPE_AGENT
#define LDS_WAIT() asm volatile("s_waitcnt lgkmcnt(0)" ::: "memory")
#define VM_WAIT() asm volatile("s_waitcnt vmcnt(0)" ::: "memory")
using pg8::cvt_pk_bf16; using pg8::bf_lo; using pg8::bf_hi; using pg8::LOG2E;

__device__ __forceinline__ float wave_sum(float v) {
#pragma unroll
    for (int o = 1; o < 64; o <<= 1) v += __shfl_xor(v, o);
    return v;
}

__device__ const unsigned char RPB_BUCKET_TAB[128] = {0, 1, 2, 3, 4, 5, 6, 7, 8, 9, 10, 11, 12, 13, 14, 15, 16, 16, 16, 17, 17, 18, 18, 18, 19, 19, 19, 20, 20, 20, 20, 21, 21, 21, 21, 22, 22, 22, 22, 22, 23, 23, 23, 23, 23, 23,
    24, 24, 24, 24, 24, 24, 25, 25, 25, 25, 25, 25, 25, 26, 26, 26, 26, 26, 26, 26, 26, 27, 27, 27, 27, 27, 27, 27, 27, 27, 27, 28, 28, 28, 28, 28, 28, 28, 28, 28, 28, 29, 29, 29, 29, 29, 29, 29, 29, 29, 29, 29, 29,
    30, 30, 30, 30, 30, 30, 30, 30, 30, 30, 30, 30, 30, 30, 31, 31, 31, 31, 31, 31, 31, 31, 31, 31, 31, 31, 31, 31, 31};

__device__ __forceinline__ void p0_transpose_item(const float* W, int ldw, bf16* WT, int ldt, int koff, int r0, LAS float* scr, int k0, int n0, int lane) {
#pragma unroll 8
    for (int i = 0; i < 32; ++i) { const int kk = 2 * i + (lane >> 5); scr[kk * 33 + (lane & 31)] = W[(size_t)(k0 + kk) * ldw + n0 + (lane & 31)]; }
    LDS_WAIT(); asm volatile("" ::: "memory");
    const int c = lane & 7;
#pragma unroll
    for (int j = 0; j < 4; ++j) { const int n = (lane >> 3) + 8 * j; const LAS float* s = scr + (8 * c) * 33 + n;
        v4u o; o.x = cvt_pk_bf16(s[0 * 33], s[1 * 33]); o.y = cvt_pk_bf16(s[2 * 33], s[3 * 33]); o.z = cvt_pk_bf16(s[4 * 33], s[5 * 33]); o.w = cvt_pk_bf16(s[6 * 33], s[7 * 33]);
        *(GAS v4u*)(WT + (size_t)(r0 + n) * ldt + koff + k0 + 8 * c) = o; }
    LDS_WAIT(); asm volatile("" ::: "memory");
}
template <int MAP> __device__ __forceinline__ int rowmap(int n) {
    if (MAP == 1) return 256 * (n >> 7) + (n & 127);
    if (MAP == 2) return 256 * (n >> 7) + 128 + (n & 127);
    if (MAP == 3) { if (n < 2048) return n; if (n < 3072) { const int c = n - 2048; return 2048 + 256 * (c >> 7) + (c & 127); } const int c = n - 3072; return 2048 + 256 * (c >> 7) + 128 + (c & 127); }
    return n;
}
template <int MAP> __device__ __forceinline__ bool p0_matrix(int& r, const float* W, int K, int N, bf16* WT, int ldt, int koff, LAS float* scr, int lane) {
    const int nblk = N / 32, items = (K / 64) * nblk;
    if (r >= items) { r -= items; return false; }
    const int kb = r / nblk, nb = r % nblk;
    p0_transpose_item(W, N, WT, ldt, koff, rowmap<MAP>(32 * nb), scr, 64 * kb, 32 * nb, lane);
    return true;
}
__device__ __forceinline__ float rms_row_to_bf16(const float* xrow, const float* gain, bf16* orow, int lane, f32x4 (&un)[4]) {
    const GAS f32x4* xr = (const GAS f32x4*)xrow + lane; const GAS f32x4* gr = (const GAS f32x4*)gain + lane;
    float s = 0.f;
#pragma unroll
    for (int j = 0; j < 4; ++j) { un[j] = xr[64 * j]; s += (un[j].x * un[j].x + un[j].y * un[j].y) + (un[j].z * un[j].z + un[j].w * un[j].w); }
    const float rstd = 1.0f / sqrtf(wave_sum(s) * (1.f / DM) + RMS_EPS);
    GAS unsigned long long* o8 = (GAS unsigned long long*)orow + lane;
#pragma unroll
    for (int j = 0; j < 4; ++j) { un[j] = (un[j] * rstd) * gr[64 * j];
        o8[64 * j] = (unsigned long long)cvt_pk_bf16(un[j].x, un[j].y) | ((unsigned long long)cvt_pk_bf16(un[j].z, un[j].w) << 32); }
    return rstd;
}

namespace moba {
constexpr int BUFB = 65536, VOFF = 32768, TILEB = 8192;
constexpr float THR = 8.0f;
__device__ __forceinline__ int crow(int r, int hi) { return (r & 3) + 8 * (r >> 2) + 4 * hi; }
__device__ __forceinline__ s16x4 vtr(LAS const unsigned char* p) { typedef short v4i16_t __attribute__((ext_vector_type(4))); return __builtin_bit_cast(s16x4, __builtin_amdgcn_ds_read_tr16_b64_v4i16((LAS v4i16_t*)p)); }
__device__ __forceinline__ float half_swap_max(float m) { auto rr = __builtin_amdgcn_permlane32_swap(__float_as_uint(m), __float_as_uint(m), false, false); return __builtin_fmaxf(__uint_as_float(rr[0]), __uint_as_float(rr[1])); }
__device__ __forceinline__ float half_swap_sum(float m) { auto rr = __builtin_amdgcn_permlane32_swap(__float_as_uint(m), __float_as_uint(m), false, false); return __uint_as_float(rr[0]) + __uint_as_float(rr[1]); }

__device__ __forceinline__ void stage_block(LAS unsigned char* lds, int buf, const bf16* Kp, const bf16* Vp, size_t R0, int hc, int wid, int lane) {
#pragma unroll
    for (int t = 0; t < 4; ++t) {
        const bf16* ks = Kp + (R0 + 64 * t + lane) * AW + hc + wid * 8;
        __builtin_amdgcn_global_load_lds((const unsigned*)ks, (LAS unsigned*)(lds + buf + t * TILEB + wid * 1024), 16, 0, 0);
        const bf16* vs = Vp + (R0 + 64 * t + 16 * (wid & 3) + (lane >> 2)) * AW + hc + (wid >> 2) * 32 + (lane & 3) * 8;
        __builtin_amdgcn_global_load_lds((const unsigned*)vs, (LAS unsigned*)(lds + buf + VOFF + t * TILEB + wid * 1024), 16, 0, 0);
    }
}
template <bool NEAR>
__device__ __forceinline__ void tile(LAS const unsigned char* kt, LAS const unsigned char* vt, const bf16x8 (&qr)[4], f32x16 (&o)[2], float& mhat, float& l_reg, bool first,
                                     float cadd, int dq, LAS const float* btab, LAS float* wsf, int lane) {
    const int r32 = lane & 31, hi = lane >> 5;
    f32x16 c;
    { const float c0 = cadd - mhat;
#pragma unroll
      for (int r = 0; r < 16; ++r) c[r] = c0; }
    f32x16 p0, p1;
    { LAS const unsigned char* kb = kt + hi * 1024 + r32 * 16;
#pragma unroll
      for (int d0 = 0; d0 < 4; ++d0) {
          const bf16x8 b0 = *(LAS const bf16x8*)(kb + d0 * 2048), b1 = *(LAS const bf16x8*)(kb + d0 * 2048 + 512);
          if (d0 == 0) { p0 = __builtin_amdgcn_mfma_f32_32x32x16_bf16(b0, qr[0], c, 0, 0, 0); p1 = __builtin_amdgcn_mfma_f32_32x32x16_bf16(b1, qr[0], c, 0, 0, 0); }
          else { p0 = __builtin_amdgcn_mfma_f32_32x32x16_bf16(b0, qr[d0], p0, 0, 0, 0); p1 = __builtin_amdgcn_mfma_f32_32x32x16_bf16(b1, qr[d0], p1, 0, 0, 0); } } }
    if (NEAR) {
#pragma unroll
        for (int r = 0; r < 16; ++r) { const int i0 = dq - ((r & 3) + 8 * (r >> 2)), i1 = i0 - 32;
            const float b0 = btab[min(max(i0, 0), 127)], b1 = btab[min(max(i1, 0), 127)];
            p0[r] = (i0 < 0) ? -INFINITY : p0[r] + b0; p1[r] = (i1 < 0) ? -INFINITY : p1[r] + b1; }
    }
    float rm = __builtin_fmaxf(p0[0], p1[0]);
#pragma unroll
    for (int r = 1; r < 16; ++r) rm = __builtin_fmaxf(rm, __builtin_fmaxf(p0[r], p1[r]));
    rm = half_swap_max(rm);
    const bool trig = first || __any(rm > THR);
    if (trig) {
        const float dl = first ? rm : __builtin_fmaxf(rm, 0.f);
        mhat += dl;
#pragma unroll
        for (int r = 0; r < 16; ++r) { p0[r] -= dl; p1[r] -= dl; }
        if (!first) {
            const float f = __builtin_amdgcn_exp2f(-dl); l_reg *= f;
            if (hi == 0) wsf[r32] = f;
            LDS_WAIT();
#pragma unroll
            for (int r = 0; r < 16; ++r) { const float fr_ = wsf[crow(r, hi)]; o[0][r] *= fr_; o[1][r] *= fr_; }
            LDS_WAIT();
        }
    }
    float sacc = 0.f;
#pragma unroll
    for (int r = 0; r < 16; ++r) { p0[r] = __builtin_amdgcn_exp2f(p0[r]); p1[r] = __builtin_amdgcn_exp2f(p1[r]); sacc += p0[r] + p1[r]; }
    l_reg += sacc;
    v4u pw[4];
    pw[0] = (v4u){cvt_pk_bf16(p0[0], p0[1]), cvt_pk_bf16(p0[2], p0[3]), cvt_pk_bf16(p0[4], p0[5]), cvt_pk_bf16(p0[6], p0[7])};
    pw[1] = (v4u){cvt_pk_bf16(p0[8], p0[9]), cvt_pk_bf16(p0[10], p0[11]), cvt_pk_bf16(p0[12], p0[13]), cvt_pk_bf16(p0[14], p0[15])};
    pw[2] = (v4u){cvt_pk_bf16(p1[0], p1[1]), cvt_pk_bf16(p1[2], p1[3]), cvt_pk_bf16(p1[4], p1[5]), cvt_pk_bf16(p1[6], p1[7])};
    pw[3] = (v4u){cvt_pk_bf16(p1[8], p1[9]), cvt_pk_bf16(p1[10], p1[11]), cvt_pk_bf16(p1[12], p1[13]), cvt_pk_bf16(p1[14], p1[15])};
    LAS const unsigned char* vb = vt + ((lane >> 4) & 1) * 32 + (lane & 3) * 8 + (4 * hi + ((lane & 15) >> 2)) * 64;
#pragma unroll
    for (int d0 = 0; d0 < 2; ++d0)
#pragma unroll
        for (int ks = 0; ks < 4; ++ks) {
            const s16x4 lo = vtr(vb + d0 * 4096 + ks * 1024), hi4 = vtr(vb + d0 * 4096 + ks * 1024 + 512);
            const bf16x8 vf = (bf16x8){lo[0], lo[1], lo[2], lo[3], hi4[0], hi4[1], hi4[2], hi4[3]};
            o[d0] = __builtin_amdgcn_mfma_f32_32x32x16_bf16(__builtin_bit_cast(bf16x8, pw[ks]), vf, o[d0], 0, 0, 0);
        }
}

__device__ __forceinline__ void unit(LAS unsigned char* lds, LAS const float* btab, LAS float* wsf_all, const bf16* Q, const bf16* Kp, const bf16* Vp, const unsigned char* SEL, bf16* AP,
                                     const float c31, int b, int h, int ib, int wid, int lane) {
    const int r32 = lane & 31, hi = lane >> 5, hc = h * HD;
    const size_t tok0 = (size_t)b * SEQ + (size_t)ib * MBLK;
    const size_t qrow = tok0 + wid * 32 + r32;
    LAS float* wsf = wsf_all + wid * 64;
    bf16x8 qr[4];
#pragma unroll
    for (int d0 = 0; d0 < 4; ++d0) qr[d0] = *(const bf16x8*)(Q + qrow * AW + hc + d0 * 16 + hi * 8);
    unsigned sel = (ib >= 4) ? (unsigned)SEL[qrow * NH + h] : ((1u << ib) - 1u);
    float mhat = 0.f, l_reg = 0.f; f32x16 o[2];
#pragma unroll
    for (int r = 0; r < 16; ++r) { o[0][r] = 0.f; o[1][r] = 0.f; }
    const int nblk = ib + 1, qloc = wid * 32 + r32;
    stage_block(lds, 0, Kp, Vp, tok0, hc, wid, lane);
    for (int i = 0; i < nblk; ++i) {
        VM_WAIT(); __syncthreads();
        if (i + 1 < nblk) stage_block(lds, ((i + 1) & 1) * BUFB, Kp, Vp, (size_t)b * SEQ + (size_t)(ib - 1 - i) * MBLK, hc, wid, lane);
        LAS const unsigned char* buf = lds + (i & 1) * BUFB;
        if (i == 0) {
            const int ktmax = wid >> 1;
            for (int kt = 0; kt <= ktmax; ++kt) {
                const int dmin = wid * 32 - 64 * kt - 63;
                if (dmin < 113) tile<true>(buf + kt * TILEB, buf + VOFF + kt * TILEB, qr, o, mhat, l_reg, kt == 0, 0.f, qloc - 64 * kt - 4 * hi, btab, wsf, lane);
                else tile<false>(buf + kt * TILEB, buf + VOFF + kt * TILEB, qr, o, mhat, l_reg, kt == 0, c31, 0, btab, wsf, lane);
            }
        } else {
            const int n = ib - i;
            const bool selb = (sel >> n) & 1u;
            if (__any(selb)) {
                for (int kt = 0; kt < 4; ++kt) {
                    const int dmin = wid * 32 + 256 * i - 64 * kt - 63;
                    if (dmin < 113) tile<true>(buf + kt * TILEB, buf + VOFF + kt * TILEB, qr, o, mhat, l_reg, false, selb ? 0.f : -INFINITY, qloc + 256 * i - 64 * kt - 4 * hi, btab, wsf, lane);
                    else tile<false>(buf + kt * TILEB, buf + VOFF + kt * TILEB, qr, o, mhat, l_reg, false, selb ? c31 : -INFINITY, 0, btab, wsf, lane);
                }
            }
        }
    }
    const float lt = half_swap_sum(l_reg);
    if (hi == 0) wsf[32 + r32] = __builtin_amdgcn_rcpf(lt);
    LDS_WAIT();
    bf16* orow = AP + (tok0 + wid * 32) * DM + hc + r32;
#pragma unroll
    for (int r = 0; r < 16; ++r) { const int q = crow(r, hi); const float rl = wsf[32 + q];
        orow[(size_t)q * DM] = (bf16)(cvt_pk_bf16(o[0][r] * rl, 0.f) & 0xffffu); orow[(size_t)q * DM + 32] = (bf16)(cvt_pk_bf16(o[1][r] * rl, 0.f) & 0xffffu); }
    LDS_WAIT();
    __syncthreads();
}
}

constexpr size_t MiB = 1u << 20;
constexpr size_t WS_CTL = 0, CTL_ZERO_BYTES = 1 * MiB;
constexpr size_t WS_W1GU = 1 * MiB;
constexpr size_t WS_W1D  = 12 * MiB;
constexpr size_t WS_W2GU = 18 * MiB;
constexpr size_t WS_W2D  = 29 * MiB;
constexpr size_t WS_WIN  = 35 * MiB;
constexpr size_t WS_WAB  = 43 * MiB;
constexpr size_t WS_WOUT = 45 * MiB;
constexpr size_t WS_SMALL = 47 * MiB;
constexpr size_t WS_UPART = WS_SMALL, WS_KMEAN = WS_SMALL + 1 * MiB, WS_G = WS_SMALL + 2 * MiB, WS_RSTD = WS_SMALL + 4 * MiB, WS_SEL = WS_SMALL + 4 * MiB + 256 * 1024;
constexpr size_t WS_XN   = 52 * MiB;
constexpr size_t WS_ACT  = 84 * MiB;
constexpr size_t WS_R    = 172 * MiB, WS_SGP = 204 * MiB;
constexpr size_t WS_END  = 236 * MiB;
static_assert(WS_W1GU + (size_t)2 * DFF * DM * 2 <= WS_W1D && WS_W1D + (size_t)DFF * DM * 2 <= WS_W2GU && WS_W2GU + (size_t)2 * DFF * DM * 2 <= WS_W2D && WS_W2D + (size_t)DFF * DM * 2 <= WS_WIN, "weights map");
static_assert(WS_ACT + (size_t)M_TOK * DFF * 2 <= WS_R && WS_SEL + (size_t)M_TOK * 8 <= WS_XN, "activation map");
constexpr int CW_BAR = 4096;

constexpr int RING_OFF = 0, RING_BYTES = 131072;
constexpr int AUX_OFF = RING_BYTES;
constexpr int LDSCTL_OFF = RING_BYTES + 8192, MISC_OFF = LDSCTL_OFF + 320;
constexpr int LDS_BYTES = 147456;

#define XB_TMO      128
#define XB_XCNT(j)  (256  + 64 * (j))
#define XB_XSUB(j)  (1280 + 64 * (j))
#define XB_XGEN(j)  (2304 + 64 * (j))
#define XB_TOP      3328
#define XB_TOPGEN   3392
#define XCD_BAR_WORDS 3456
#define XB_SPIN_CAP (1u << 18)

__device__ __forceinline__ unsigned xb_ld(unsigned* p)              { return __hip_atomic_load(p, __ATOMIC_RELAXED, __HIP_MEMORY_SCOPE_AGENT); }
__device__ __forceinline__ unsigned xb_add(unsigned* p, unsigned v) { return __hip_atomic_fetch_add(p, v, __ATOMIC_RELAXED, __HIP_MEMORY_SCOPE_AGENT); }
__device__ __forceinline__ unsigned xb_xcc_id() { return (unsigned)__builtin_amdgcn_s_getreg((3 << 11) | 20) & 0xFu; }
#define XB_SPIN(cond, bar) do { unsigned _sp = 0; while (cond) { __builtin_amdgcn_s_sleep(1); \
    if ((++_sp & 255u) == 0u) { if (xb_ld(&(bar)[XB_TMO])) break; if (_sp > XB_SPIN_CAP) { atomicAdd(&(bar)[XB_TMO], 1u); break; } } } } while (0)

struct XcdBarrier {
    unsigned* bar; unsigned x;
    volatile LAS unsigned* st;
};

__device__ __forceinline__ XcdBarrier xcd_barrier_post(unsigned* bar, volatile LAS unsigned* st) {
    XcdBarrier b; b.bar = bar; b.x = xb_xcc_id(); b.st = st;
    if (threadIdx.x == 0) (void)xb_add(&bar[XB_XCNT(b.x)], 1u);
    return b;
}
__device__ __forceinline__ void xcd_barrier_complete(unsigned* bar, unsigned x, unsigned& nloc, unsigned& nx) {
    const unsigned G = gridDim.x * gridDim.y * gridDim.z;
    unsigned sum, cnt, mine, sp = 0u;
    for (;;) {
        sum = 0u; cnt = 0u; mine = 0u;
#pragma unroll
        for (unsigned j = 0; j < 16; ++j) { const unsigned c = xb_ld(&bar[XB_XCNT(j)]); sum += c; cnt += (c > 0u) ? 1u : 0u; mine = (j == x) ? c : mine; }
        if (sum == G) break;
        __builtin_amdgcn_s_sleep(1);
        if ((++sp & 255u) == 0u) { if (xb_ld(&bar[XB_TMO])) break; if (sp > XB_SPIN_CAP) { atomicAdd(&bar[XB_TMO], 1u); break; } }
    }
    nloc = mine > 0u ? mine : 1u; nx = cnt > 0u ? cnt : 1u;
}

__device__ __forceinline__ void xcd_barrier(const XcdBarrier& b) {
    asm volatile("s_waitcnt vmcnt(0)" ::: "memory");
    __syncthreads();
    if (threadIdx.x == 0) {
        unsigned* bar = b.bar;
        __builtin_amdgcn_s_waitcnt(0);
        unsigned nloc = b.st[0], nx = b.st[1];
        if (nloc == 0u) { xcd_barrier_complete(bar, b.x, nloc, nx); b.st[0] = nloc; b.st[1] = nx; }
        const unsigned old = xb_add(&bar[XB_XSUB(b.x)], 1u);
        const unsigned gen = old / nloc;
        if (old + 1u == (gen + 1u) * nloc) {
            __builtin_amdgcn_fence(__ATOMIC_RELEASE, "agent");
            asm volatile("s_waitcnt vmcnt(0)" ::: "memory");
            const unsigned og = xb_add(&bar[XB_TOP], 1u);
            const unsigned tg = og / nx;
            if (og + 1u == (tg + 1u) * nx) xb_add(&bar[XB_TOPGEN], 1u);
            else XB_SPIN(xb_ld(&bar[XB_TOPGEN]) == tg, bar);
            __builtin_amdgcn_fence(__ATOMIC_ACQUIRE, "agent");
            xb_add(&bar[XB_XGEN(b.x)], 1u);
            asm volatile("s_waitcnt vmcnt(0)" ::: "memory");
        } else {
            XB_SPIN(xb_ld(&bar[XB_XGEN(b.x)]) == gen, bar);
            __builtin_amdgcn_fence(__ATOMIC_ACQUIRE, "agent");
            asm volatile("s_waitcnt vmcnt(0)" ::: "memory");
        }
    }
    __syncthreads();
}


struct Args { const float* in[18]; float* out; unsigned char* ws; };
__global__ void __launch_bounds__(NWAVES * 64, 2) hybrid_fwd(Args args) {
    extern __shared__ __attribute__((aligned(16))) unsigned char lds_raw[];
    LAS unsigned char* lds = (LAS unsigned char*)lds_raw;
#define FRESH_IDS() int tid = threadIdx.x; asm volatile("" : "+v"(tid)); const int lane = tid & 63, wave = __builtin_amdgcn_readfirstlane(tid >> 6); const int gw = vcu * NWAVES + wave, NGW = G * NWAVES; (void)lane; (void)wave; (void)gw; (void)NGW
    const int G = gridDim.x, bx = blockIdx.x;
    const int vcu = (G % 8 == 0) ? (bx % 8) * (G / 8) + bx / 8 : bx;
    unsigned char* ws = args.ws;
    gu32* ctl = (gu32*)(ws + WS_CTL);
    const float* x = args.in[0];
    float* out = args.out;
    bf16* W1GU = (bf16*)(ws + WS_W1GU); bf16* W1D = (bf16*)(ws + WS_W1D); bf16* W2GU = (bf16*)(ws + WS_W2GU); bf16* W2D = (bf16*)(ws + WS_W2D);
    bf16* WIN = (bf16*)(ws + WS_WIN); bf16* WAB = (bf16*)(ws + WS_WAB); bf16* WOUT = (bf16*)(ws + WS_WOUT);
    bf16* XN = (bf16*)(ws + WS_XN); bf16* ACT = (bf16*)(ws + WS_ACT); bf16* QKVZ = ACT; bf16* MERGED = ACT; bf16* AP = XN;
    bf16* RB = (bf16*)(ws + WS_R); bf16* SGP = (bf16*)(ws + WS_SGP);
    float* UPART = (float*)(ws + WS_UPART); float* KMEAN = (float*)(ws + WS_KMEAN); float* GM = (float*)(ws + WS_G); float* RSTD = (float*)(ws + WS_RSTD);
    unsigned char* SEL = ws + WS_SEL;

    for (int u = threadIdx.x; u < (LDS_BYTES - LDSCTL_OFF) / 4; u += NWAVES * 64) ((LAS unsigned*)(lds + LDSCTL_OFF))[u] = 0u;
    __syncthreads();
    XcdBarrier bar = xcd_barrier_post((unsigned*)(ctl + CW_BAR), (volatile LAS unsigned*)(lds + MISC_OFF) + 8);
#define GRID_BAR() xcd_barrier(bar)

    {   FRESH_IDS();
        LAS float* coef = (LAS float*)(lds + RING_OFF);
        for (int it = bx; it < 256; it += G) {
            if (tid < 256) { const int rr = tid >> 7, d = tid & 127, kp = 2 * it + rr, g = kp >> 7, c = kp & 127;
                coef[rr * 128 + d] = args.in[7][(size_t)(g * 128 + c) * 128 + d] * args.in[8][g * 128 + d]; }
            __syncthreads();
            { const int rr = tid >> 8, nq = tid & 255, kp = 2 * it + rr, g = kp >> 7;
              const float* wp = args.in[10] + (size_t)(g * 128) * DM + 4 * nq; f32x4 a = {0.f, 0.f, 0.f, 0.f};
#pragma unroll 8
              for (int d = 0; d < 128; ++d) a += *(const f32x4*)(wp + (size_t)d * DM) * coef[rr * 128 + d];
              bf16* dst = WAB + (size_t)(4 * nq) * DM + 512 + kp;
              dst[0] = (bf16)(cvt_pk_bf16(a.x, 0.f) & 0xffffu); dst[DM] = (bf16)(cvt_pk_bf16(a.y, 0.f) & 0xffffu); dst[2 * DM] = (bf16)(cvt_pk_bf16(a.z, 0.f) & 0xffffu); dst[3 * DM] = (bf16)(cvt_pk_bf16(a.w, 0.f) & 0xffffu); }
            __syncthreads();
        }
        LAS float* scr = (LAS float*)(lds + RING_OFF + wave * 16384);
        constexpr int I_GU = (DM / 64) * (DFF / 32), I_D = (DFF / 64) * (DM / 32), I_IN = (DM / 64) * (INW / 32), I_A = (AW / 64) * (DM / 32), I_O = (DM / 64) * (DM / 32);
        constexpr int NITEMS = 4 * I_GU + 2 * I_D + I_IN + I_A + I_O;
        for (int it = gw; it < NITEMS; it += NGW) {
            int r = it;
            if (p0_matrix<1>(r, args.in[2], DM, DFF, W1GU, DM, 0, scr, lane)) continue;
            if (p0_matrix<2>(r, args.in[3], DM, DFF, W1GU, DM, 0, scr, lane)) continue;
            if (p0_matrix<0>(r, args.in[4], DFF, DM, W1D, DFF, 0, scr, lane)) continue;
            if (p0_matrix<3>(r, args.in[6], DM, INW, WIN, DM, 0, scr, lane)) continue;
            if (p0_matrix<0>(r, args.in[9], AW, DM, WAB, DM, 0, scr, lane)) continue;
            if (p0_matrix<0>(r, args.in[11], DM, DM, WOUT, DM, 0, scr, lane)) continue;
            if (p0_matrix<1>(r, args.in[13], DM, DFF, W2GU, DM, 0, scr, lane)) continue;
            if (p0_matrix<2>(r, args.in[14], DM, DFF, W2GU, DM, 0, scr, lane)) continue;
            p0_matrix<0>(r, args.in[15], DFF, DM, W2D, DFF, 0, scr, lane);
        }
        for (int m = gw; m < M_TOK; m += NGW) { f32x4 un[4]; (void)rms_row_to_bf16(x + (size_t)m * DM, args.in[1], XN + (size_t)m * DM, lane, un); }
    }
    GRID_BAR();

    { pg8::Gemm g{XN, W1GU, M_TOK, 2 * DFF, DM}; pg8::StaticOrder S; S.init(M_TOK, 2 * DFF, G, bx);
      pg8::EpiSwiGLU E{ACT, DFF};
      pg8::gemm_phase<pg8::EpiSwiGLU, pg8::StaticOrder, true, true>(lds + RING_OFF, g, S, E); }
    GRID_BAR();
    { pg8::Gemm g{ACT, W1D, M_TOK, DM, DFF}; pg8::StaticOrder S; S.init(M_TOK, DM, G, bx);
      pg8::EpiResF32 E{x, out, DM, 0.5f};
      pg8::gemm_phase<pg8::EpiResF32, pg8::StaticOrder, true, true>(lds + RING_OFF, g, S, E); }
    GRID_BAR();
    {   FRESH_IDS();
        LAS float* red = (LAS float*)(lds + RING_OFF);
        for (int rg = bx; rg < M_TOK / 64; rg += G) {
            f32x4 cs[4] = {{0.f, 0.f, 0.f, 0.f}, {0.f, 0.f, 0.f, 0.f}, {0.f, 0.f, 0.f, 0.f}, {0.f, 0.f, 0.f, 0.f}};
            for (int i = 0; i < 8; ++i) { const int m = rg * 64 + wave * 8 + i; f32x4 un[4];
                const float rs = rms_row_to_bf16(out + (size_t)m * DM, args.in[5], XN + (size_t)m * DM, lane, un);
                if (lane == 0) RSTD[m] = rs;
#pragma unroll
                for (int j = 0; j < 4; ++j) cs[j] += un[j]; }
#pragma unroll
            for (int j = 0; j < 4; ++j) *(LAS f32x4*)(red + wave * 1024 + 256 * j + 4 * lane) = cs[j];
            __syncthreads();
            for (int c = tid; c < 1024; c += NWAVES * 64) { float s = 0.f;
#pragma unroll
                for (int w = 0; w < 8; ++w) s += red[w * 1024 + c];
                UPART[(size_t)rg * 1024 + c] = s; }
            __syncthreads();
        }
    }
    GRID_BAR();
    {   FRESH_IDS();
        LAS float* ub = (LAS float*)(lds + RING_OFF);
        LAS float* red = ub + 1024;
        const float* Wk = args.in[6] + AW;
        for (int it = bx; it < 256; it += G) {
            const int bn = it >> 2, cq = it & 3;
            if ((bn & 7) == 7) continue;
            for (int i = tid; i < 1024; i += NWAVES * 64) ub[i] = ((UPART[(size_t)(4 * bn) * 1024 + i] + UPART[(size_t)(4 * bn + 1) * 1024 + i]) + (UPART[(size_t)(4 * bn + 2) * 1024 + i] + UPART[(size_t)(4 * bn + 3) * 1024 + i])) * (1.f / 256.f);
            __syncthreads();
            const int c = cq * 128 + (tid & 127), kg = tid >> 7; float a = 0.f;
#pragma unroll 8
            for (int i = 0; i < 256; ++i) a += ub[kg * 256 + i] * Wk[(size_t)(kg * 256 + i) * INW + c];
            red[kg * 128 + (tid & 127)] = a;
            __syncthreads();
            if (tid < 128) KMEAN[(size_t)bn * AW + cq * 128 + tid] = (red[tid] + red[128 + tid]) + (red[256 + tid] + red[384 + tid]);
            __syncthreads();
        }
    }
    GRID_BAR();
    {   FRESH_IDS();
        LAS float* wq = (LAS float*)(lds + RING_OFF);
        for (int it = bx; it < 256; it += G) {
            for (int e = tid; e < 2048; e += NWAVES * 64) { const int r = e >> 9, cc = e & 511; wq[(r * 8 + (cc >> 6)) * 65 + (cc & 63)] = args.in[6][(size_t)(4 * it + r) * INW + cc]; }
            __syncthreads();
            const int b = tid >> 6, hn = tid & 63, h = hn >> 3, n = hn & 7;
            f32x4 g4 = {0.f, 0.f, 0.f, 0.f};
            if (n != 7) {
                const float* km = KMEAN + (size_t)(b * 8 + n) * AW + h * 64;
#pragma unroll 4
                for (int d = 0; d < 64; d += 4) { const f32x4 k4 = *(const f32x4*)(km + d);
#pragma unroll
                    for (int r = 0; r < 4; ++r) { const LAS float* w = wq + (r * 8 + h) * 65 + d; g4[r] += (w[0] * k4.x + w[1] * k4.y) + (w[2] * k4.z + w[3] * k4.w); } }
            }
            *(f32x4*)(GM + ((size_t)(b * 64 + hn)) * DM + 4 * it) = g4;
            __syncthreads();
        }
    }
    GRID_BAR();
    {   FRESH_IDS();
        LAS float* gl = (LAS float*)(lds + RING_OFF);
        for (int it = bx; it < 256; it += G) {
            const int b = it >> 5, s0 = 1024 + 32 * (it & 31); const size_t t0 = (size_t)b * SEQ + s0;
            const int rg = wave >> 2, ct = wave & 3, r = lane & 15, g4 = lane >> 4;
            const size_t rowA = t0 + 16 * rg + r; const float rs = RSTD[rowA];
            const float* ap = out + rowA * DM + 4 * g4; const float* gp = args.in[5] + 4 * g4; const float* bp = GM + ((size_t)(b * 64 + 16 * ct + r)) * DM + 4 * g4;
            f32x4 acc = {0.f, 0.f, 0.f, 0.f};
#pragma unroll 4
            for (int kk = 0; kk < 64; ++kk) { f32x4 a4 = *(const f32x4*)(ap + 16 * kk); const f32x4 gg = *(const f32x4*)(gp + 16 * kk), b4 = *(const f32x4*)(bp + 16 * kk);
                a4 = (a4 * rs) * gg;
                acc = __builtin_amdgcn_mfma_f32_16x16x4f32(a4.x, b4.x, acc, 0, 0, 0); acc = __builtin_amdgcn_mfma_f32_16x16x4f32(a4.y, b4.y, acc, 0, 0, 0);
                acc = __builtin_amdgcn_mfma_f32_16x16x4f32(a4.z, b4.z, acc, 0, 0, 0); acc = __builtin_amdgcn_mfma_f32_16x16x4f32(a4.w, b4.w, acc, 0, 0, 0); }
#pragma unroll
            for (int q = 0; q < 4; ++q) gl[(16 * rg + 4 * g4 + q) * 65 + 16 * ct + r] = acc[q];
            __syncthreads();
            if (tid < 256) { const int row = tid >> 3, h = tid & 7, ib = (s0 + row) >> 8; float gv[8];
#pragma unroll
                for (int n = 0; n < 8; ++n) gv[n] = (n < ib) ? gl[row * 65 + h * 8 + n] : -INFINITY;
                unsigned mask = 0u;
#pragma unroll
                for (int k = 0; k < 3; ++k) { float best = -INFINITY; int bi = 0;
#pragma unroll
                    for (int n = 0; n < 8; ++n) { const bool take = !((mask >> n) & 1u) && (gv[n] > best); best = take ? gv[n] : best; bi = take ? n : bi; }
                    mask |= 1u << bi; }
                SEL[(t0 + row) * NH + h] = (unsigned char)mask; }
            __syncthreads();
        }
    }
    { pg8::Gemm g{XN, WIN, M_TOK, INW, DM}; pg8::StaticOrder S; S.init(M_TOK, INW, G, bx);
      pg8::EpiWin E{QKVZ, (size_t)M_TOK * AW, 0.125f * LOG2E, RB, SGP};
      pg8::gemm_phase<pg8::EpiWin, pg8::StaticOrder, true, true>(lds + RING_OFF, g, S, E); }
    GRID_BAR();
    {   FRESH_IDS();
        const bf16* Q = QKVZ; const bf16* Kp = QKVZ + (size_t)M_TOK * AW; const bf16* Vp = QKVZ + (size_t)2 * M_TOK * AW; const bf16* Z = QKVZ + (size_t)3 * M_TOK * AW;
        LAS float* btab = (LAS float*)(lds + AUX_OFF); LAS float* wsf = (LAS float*)(lds + AUX_OFF + 1024);
        for (int v = vcu; v < 256; v += G) {
            const int bh = v >> 2, j = v & 3, b = bh >> 3, h = bh & 7;
            __syncthreads();
            if (tid < 128) btab[tid] = args.in[16][RPB_BUCKET_TAB[tid] * NH + h] * LOG2E;
            __syncthreads();
            const float c31 = args.in[16][31 * NH + h] * LOG2E;
            moba::unit(lds + RING_OFF, btab, wsf, Q, Kp, Vp, SEL, AP, c31, b, h, 7 - j, wave, lane);
            moba::unit(lds + RING_OFF, btab, wsf, Q, Kp, Vp, SEL, AP, c31, b, h, j, wave, lane);
        }
        for (int tb = bx; tb < M_TOK / 64; tb += G) {
            for (int it = tid; it < 4096; it += NWAVES * 64) { const int tl = it >> 6, co = it & 63; const size_t t = (size_t)tb * 64 + tl; const int s = (int)(t & (SEQ - 1)), w = 2 << (co >> 4), cnt = min(s + 1, w);
                float a[8] = {0.f, 0.f, 0.f, 0.f, 0.f, 0.f, 0.f, 0.f}; v4u z0 = *(const v4u*)(Z + t * PW + co * 8);
                for (int jj = 0; jj < cnt; ++jj) { const v4u z = *(const v4u*)(Z + (t - jj) * PW + co * 8);
                    a[0] += bf_lo(z.x); a[1] += bf_hi(z.x); a[2] += bf_lo(z.y); a[3] += bf_hi(z.y); a[4] += bf_lo(z.z); a[5] += bf_hi(z.z); a[6] += bf_lo(z.w); a[7] += bf_hi(z.w); }
                const float ic = 1.0f / (float)cnt;
                v4u o; o.x = cvt_pk_bf16(a[0] * ic - bf_lo(z0.x), a[1] * ic - bf_hi(z0.x)); o.y = cvt_pk_bf16(a[2] * ic - bf_lo(z0.y), a[3] * ic - bf_hi(z0.y));
                o.z = cvt_pk_bf16(a[4] * ic - bf_lo(z0.z), a[5] * ic - bf_hi(z0.z)); o.w = cvt_pk_bf16(a[6] * ic - bf_lo(z0.w), a[7] * ic - bf_hi(z0.w));
                *(v4u*)(AP + t * DM + AW + co * 8) = o; }
        }
    }
    GRID_BAR();
    { pg8::Gemm g{AP, WAB, M_TOK, DM, DM}; pg8::StaticOrder S; S.init(M_TOK, DM, G, bx);
      pg8::EpiMerged E{RB, SGP, MERGED};
      pg8::gemm_phase<pg8::EpiMerged, pg8::StaticOrder, true, true>(lds + RING_OFF, g, S, E); }
    GRID_BAR();
    { pg8::Gemm g{MERGED, WOUT, M_TOK, DM, DM}; pg8::StaticOrder S; S.init(M_TOK, DM, G, bx);
      pg8::EpiResF32 E{out, out, DM, 1.0f};
      pg8::gemm_phase<pg8::EpiResF32, pg8::StaticOrder, true, true>(lds + RING_OFF, g, S, E); }
    GRID_BAR();
    { FRESH_IDS();
    for (int m = gw; m < M_TOK; m += NGW) { f32x4 un[4]; (void)rms_row_to_bf16(out + (size_t)m * DM, args.in[12], XN + (size_t)m * DM, lane, un); } }
    GRID_BAR();
    { pg8::Gemm g{XN, W2GU, M_TOK, 2 * DFF, DM}; pg8::StaticOrder S; S.init(M_TOK, 2 * DFF, G, bx);
      pg8::EpiSwiGLU E{ACT, DFF};
      pg8::gemm_phase<pg8::EpiSwiGLU, pg8::StaticOrder, true, true>(lds + RING_OFF, g, S, E); }
    GRID_BAR();
    { pg8::Gemm g{ACT, W2D, M_TOK, DM, DFF}; pg8::StaticOrder S; S.init(M_TOK, DM, G, bx);
      pg8::EpiResF32 E{out, out, DM, 0.5f};
      pg8::gemm_phase<pg8::EpiResF32, pg8::StaticOrder, true, true>(lds + RING_OFF, g, S, E); }
    GRID_BAR();
    { FRESH_IDS();
    for (int m = gw; m < M_TOK; m += NGW) {
        GAS f32x4* xr = (GAS f32x4*)(out + (size_t)m * DM) + lane; const GAS f32x4* gr = (const GAS f32x4*)args.in[17] + lane;
        f32x4 v[4]; float s = 0.f;
#pragma unroll
        for (int j = 0; j < 4; ++j) { v[j] = xr[64 * j]; s += (v[j].x * v[j].x + v[j].y * v[j].y) + (v[j].z * v[j].z + v[j].w * v[j].w); }
        const float rstd = 1.0f / sqrtf(wave_sum(s) * (1.f / DM) + RMS_EPS);
#pragma unroll
        for (int j = 0; j < 4; ++j) xr[64 * j] = (v[j] * rstd) * gr[64 * j];
    } }
#undef GRID_BAR
}

extern "C" void kernel_launch(void* const* d_in, const int* in_sizes, int n_in, void* d_out, int out_size, void* d_ws, size_t ws_size, hipStream_t stream) {
    static int grid = 0;
    if (grid == 0) {
        if (n_in != 18 || in_sizes[0] != M_TOK * DM || out_size != M_TOK * DM || ws_size < WS_END) { fprintf(stderr, "kernel_launch: unexpected problem shape / workspace (n_in %d, in0 %d, out %d, ws %zu); nothing launched\n", n_in, n_in > 0 ? in_sizes[0] : -1, out_size, ws_size); grid = -1; return; }
        int dev = 0, cus = 0, per_cu = 0;
        if (hipGetDevice(&dev) != hipSuccess || hipDeviceGetAttribute(&cus, hipDeviceAttributeMultiprocessorCount, dev) != hipSuccess) { fprintf(stderr, "kernel_launch: device query failed\n"); grid = -1; return; }
        if (hipFuncSetAttribute((const void*)hybrid_fwd, hipFuncAttributeMaxDynamicSharedMemorySize, LDS_BYTES) != hipSuccess) { fprintf(stderr, "kernel_launch: hipFuncSetAttribute failed\n"); grid = -1; return; }
        if (hipOccupancyMaxActiveBlocksPerMultiprocessor(&per_cu, (const void*)hybrid_fwd, NWAVES * 64, LDS_BYTES) != hipSuccess || per_cu < 1) { fprintf(stderr, "kernel_launch: occupancy query reports %d workgroups per CU\n", per_cu); }
        (void)hipGetLastError();
        grid = cus;
    }
    if (grid < 0) return;
    if (hipMemsetAsync((char*)d_ws + WS_CTL, 0, CTL_ZERO_BYTES, stream) != hipSuccess) { fprintf(stderr, "kernel_launch: hipMemsetAsync failed\n"); return; }
    Args a{};
    for (int i = 0; i < 18; ++i) a.in[i] = (const float*)d_in[i];
    a.out = (float*)d_out; a.ws = (unsigned char*)d_ws;
    hipLaunchKernelGGL(hybrid_fwd, dim3(grid), dim3(NWAVES * 64), LDS_BYTES, stream, a);
    const hipError_t le = hipPeekAtLastError();
    if (le != hipSuccess) fprintf(stderr, "kernel_launch: launch failed: %s\n", hipGetErrorName(le));
}
```
